# Optimizing an MI355X kernel written in HIP

```python
import math
import jax, jax.numpy as jnp
from jax import lax
import numpy as np

D_MODEL = 1024
BATCH = 4
SEQ = 4096
DEPTH = 1

GLA_HEADS = 4
GLA_DK = 64
GLA_DV = 128
GLA_RANK = 16
GLA_TAU = 16.0
GLA_CHUNK = 16
DIFF_HEADS = 4
DIFF_DH = 64
DIFF_DV = 2 * DIFF_DH
Q_BLOCK = 128
ALIBI_MAX_BIAS = 8.0
D_FF = 2816
EPS = 1e-6
N_BRANCH = 2
N_MOD = 9

GLA_KW = GLA_HEADS * GLA_DK
GLA_VW = GLA_HEADS * GLA_DV
DIFF_QW = DIFF_HEADS * 2 * DIFF_DH
DIFF_VW = DIFF_HEADS * DIFF_DV
IN_SIZES = (GLA_KW, GLA_KW, GLA_VW, GLA_VW, GLA_RANK, DIFF_QW, DIFF_QW, DIFF_VW, N_BRANCH * D_MODEL)
IN_COLS = GLA_KW * 2 + GLA_VW * 2 + GLA_RANK + DIFF_QW * 2 + DIFF_VW + N_BRANCH * D_MODEL

kernel_name = "hybrid_gla_diffattn_macaron_adaln"


def split_points(sizes):
    pts, acc = [], 0
    for s in sizes[:-1]:
        acc += s
        pts.append(acc)
    return pts


def rmsnorm(x, g):
    xf = x.astype(jnp.float32)
    y = xf * lax.rsqrt(jnp.mean(xf * xf, axis=-1, keepdims=True) + EPS)
    return (y * g.astype(jnp.float32)).astype(x.dtype)


def modulate(xn, shift, scale):
    return xn * (1.0 + scale[:, None, :]) + shift[:, None, :]


def swiglu(x, w_in, w_out):
    g, u = jnp.split(x @ w_in, 2, axis=-1)
    return (jax.nn.silu(g) * u) @ w_out


def gla(q, k, v, a_low, w2, b2):
    B, S, _ = q.shape
    C = GLA_CHUNK
    N = S // C
    f32 = jnp.float32
    log_a = jax.nn.log_sigmoid((a_low @ w2 + b2).astype(f32)) / GLA_TAU

    def chunks(t, d):
        return t.reshape(B, N, C, GLA_HEADS, d).transpose(0, 3, 1, 2, 4).astype(f32)

    qc = chunks(q, GLA_DK) * (GLA_DK ** -0.5)
    kc = chunks(k, GLA_DK)
    vc = chunks(v, GLA_DV)
    b = jnp.cumsum(chunks(log_a, GLA_DK), axis=3)
    b_last = b[:, :, :, -1:, :]

    causal = jnp.tril(jnp.ones((C, C), dtype=bool))
    diff = b[:, :, :, :, None, :] - b[:, :, :, None, :, :]
    decay = jnp.exp(jnp.where(causal[:, :, None], diff, -jnp.inf))
    scores = jnp.einsum('bhntk,bhnsk,bhntsk->bhnts', qc, kc, decay)
    o_intra = jnp.einsum('bhnts,bhnsv->bhntv', scores, vc)

    kv = jnp.einsum('bhnck,bhncv->nbhkv', kc * jnp.exp(b_last - b), vc)
    chunk_decay = jnp.exp(b_last[:, :, :, 0, :]).transpose(2, 0, 1, 3)

    def step(state, inp):
        dec, kvn = inp
        return dec[..., None] * state + kvn, state

    s0 = jnp.zeros((B, GLA_HEADS, GLA_DK, GLA_DV), f32)
    _, s_prev = lax.scan(step, s0, (chunk_decay, kv))
    o_inter = jnp.einsum('bhnck,nbhkv->bhncv', qc * jnp.exp(b), s_prev)
    o = o_intra + o_inter
    return o.transpose(0, 2, 3, 1, 4).reshape(B, S, GLA_HEADS, GLA_DV).astype(v.dtype)


def diff_attention(q, k, v, lq1, lk1, lq2, lk2, lam_init):
    B, S, _ = q.shape
    H = DIFF_HEADS
    f32 = jnp.float32
    q = q.reshape(B, S, H, 2, DIFF_DH).transpose(0, 2, 3, 1, 4) * (DIFF_DH ** -0.5)
    k = k.reshape(B, S, H, 2, DIFF_DH).transpose(0, 2, 3, 1, 4)
    v = v.reshape(B, S, H, DIFF_DV).transpose(0, 2, 1, 3)
    lam = (jnp.exp(jnp.sum(lq1.astype(f32) * lk1.astype(f32)))
           - jnp.exp(jnp.sum(lq2.astype(f32) * lk2.astype(f32))) + lam_init)
    slopes = jnp.exp2(-ALIBI_MAX_BIAS * jnp.arange(1, H + 1, dtype=f32) / H)
    NB = S // Q_BLOCK
    qb = q.reshape(B, H, 2, NB, Q_BLOCK, DIFF_DH).transpose(3, 0, 1, 2, 4, 5)
    kpos = jnp.arange(S)

    def block(args):
        qi, i = args
        qpos = i * Q_BLOCK + jnp.arange(Q_BLOCK)
        rel = (qpos[:, None] - kpos[None, :]).astype(f32)
        s = jnp.einsum('bhiqd,bhikd->bhiqk', qi, k).astype(f32)
        s = s - slopes[None, :, None, None, None] * rel
        s = jnp.where(rel >= 0, s, -jnp.inf)
        p = jax.nn.softmax(s, axis=-1)
        a = p[:, :, 0] - lam * p[:, :, 1]
        return jnp.einsum('bhqk,bhkv->bhqv', a.astype(v.dtype), v)

    o = lax.map(block, (qb, jnp.arange(NB)))
    return o.transpose(1, 0, 3, 2, 4).reshape(B, S, H, DIFF_DV)


def token_mixer(u, w_in, gla_alpha_w2, gla_alpha_b, gla_head_norm,
                diff_lq1, diff_lk1, diff_lq2, diff_lk2, diff_head_norm,
                w_branch_a, w_branch_b, w_out, lam_init):
    B, S, _ = u.shape
    proj = u @ w_in
    gq, gk, gv, gr, ga, dq, dk, dv, gates = jnp.split(proj, split_points(IN_SIZES), axis=-1)
    ya = gla(gq, gk, gv, ga, gla_alpha_w2, gla_alpha_b)
    ya = rmsnorm(ya, gla_head_norm) * jax.nn.silu(gr).reshape(B, S, GLA_HEADS, GLA_DV)
    ya = ya.reshape(B, S, GLA_VW) @ w_branch_a
    yb = diff_attention(dq, dk, dv, diff_lq1, diff_lk1, diff_lq2, diff_lk2, lam_init)
    yb = rmsnorm(yb, diff_head_norm) * (1.0 - lam_init)
    yb = yb.reshape(B, S, DIFF_VW) @ w_branch_b
    g_a, g_b = jnp.split(jax.nn.sigmoid(gates), N_BRANCH, axis=-1)
    return (g_a * ya + g_b * yb) @ w_out


def setup_inputs(seed: int = 0) -> dict:
    key = jax.random.key(seed)
    ks = jax.random.split(key, 24)
    L, D = DEPTH, D_MODEL
    nrm = jax.random.normal

    def gain(k, n):
        return 1.0 + 0.02 * nrm(k, (L, n), jnp.float32)

    return {
        "x": nrm(ks[0], (BATCH, SEQ, D), jnp.float32),
        "c": nrm(ks[1], (BATCH, D), jnp.float32),
        "w_ada": nrm(ks[2], (L, D, N_MOD * D), jnp.float32) * (0.5 * D ** -0.5),
        "b_ada": 0.02 * nrm(ks[3], (L, N_MOD * D), jnp.float32),
        "ffn1_norm": gain(ks[4], D),
        "ffn1_w_in": nrm(ks[5], (L, D, 2 * D_FF), jnp.float32) * D ** -0.5,
        "ffn1_w_out": nrm(ks[6], (L, D_FF, D), jnp.float32) * D_FF ** -0.5,
        "mix_norm": gain(ks[7], D),
        "w_in": nrm(ks[8], (L, D, IN_COLS), jnp.float32) * D ** -0.5,
        "gla_alpha_w2": nrm(ks[9], (L, GLA_RANK, GLA_KW), jnp.float32) * GLA_RANK ** -0.5,
        "gla_alpha_b": 0.1 * nrm(ks[10], (L, GLA_KW), jnp.float32),
        "gla_head_norm": gain(ks[11], GLA_DV),
        "diff_lq1": 0.1 * nrm(ks[12], (L, DIFF_DH), jnp.float32),
        "diff_lk1": 0.1 * nrm(ks[13], (L, DIFF_DH), jnp.float32),
        "diff_lq2": 0.1 * nrm(ks[14], (L, DIFF_DH), jnp.float32),
        "diff_lk2": 0.1 * nrm(ks[15], (L, DIFF_DH), jnp.float32),
        "diff_head_norm": gain(ks[16], DIFF_DV),
        "w_branch_a": nrm(ks[17], (L, GLA_VW, D), jnp.float32) * GLA_VW ** -0.5,
        "w_branch_b": nrm(ks[18], (L, DIFF_VW, D), jnp.float32) * DIFF_VW ** -0.5,
        "w_out": nrm(ks[19], (L, D, D), jnp.float32) * D ** -0.5,
        "ffn2_norm": gain(ks[20], D),
        "ffn2_w_in": nrm(ks[21], (L, D, 2 * D_FF), jnp.float32) * D ** -0.5,
        "ffn2_w_out": nrm(ks[22], (L, D_FF, D), jnp.float32) * D_FF ** -0.5,
        "final_norm": 1.0 + 0.02 * nrm(ks[23], (D,), jnp.float32),
    }


def reference(x, c, w_ada, b_ada, ffn1_norm, ffn1_w_in, ffn1_w_out, mix_norm, w_in,
              gla_alpha_w2, gla_alpha_b, gla_head_norm, diff_lq1, diff_lk1, diff_lq2,
              diff_lk2, diff_head_norm, w_branch_a, w_branch_b, w_out, ffn2_norm,
              ffn2_w_in, ffn2_w_out, final_norm):
    h = x
    c_act = jax.nn.silu(c)
    for l in range(DEPTH):
        lam_init = 0.8 - 0.6 * math.exp(-0.3 * l)
        mod = c_act @ w_ada[l] + b_ada[l]
        (sh1, sc1, gt1, sh2, sc2, gt2, sh3, sc3, gt3) = jnp.split(mod, N_MOD, axis=-1)
        u = modulate(rmsnorm(h, ffn1_norm[l]), sh1, sc1)
        h = h + 0.5 * gt1[:, None, :] * swiglu(u, ffn1_w_in[l], ffn1_w_out[l])
        u = modulate(rmsnorm(h, mix_norm[l]), sh2, sc2)
        m = token_mixer(u, w_in[l], gla_alpha_w2[l], gla_alpha_b[l], gla_head_norm[l],
                        diff_lq1[l], diff_lk1[l], diff_lq2[l], diff_lk2[l], diff_head_norm[l],
                        w_branch_a[l], w_branch_b[l], w_out[l], lam_init)
        h = h + gt2[:, None, :] * m
        u = modulate(rmsnorm(h, ffn2_norm[l]), sh3, sc3)
        h = h + 0.5 * gt3[:, None, :] * swiglu(u, ffn2_w_in[l], ffn2_w_out[l])
    return rmsnorm(h, final_norm)
```

```cpp
#include <hip/hip_runtime.h>
#include <stdint.h>
#include <stdio.h>

typedef unsigned short bf16_t;
constexpr int NB = 4, SEQ = 4096, DM = 1024, M = NB * SEQ, FF = 2816, NMOD = 9 * DM;
constexpr int NPROJ = 5376;
constexpr int WIN_COLS = 5136;
constexpr float EPS = 1e-6f;
constexpr float LAM_INIT = 0.2f;
constexpr size_t MiB = 1u << 20;
constexpr size_t WS_CTL = 0;
constexpr size_t WS_MOD = 1 * MiB;
constexpr size_t WS_LAM = WS_MOD + 4 * NMOD * 4;
constexpr size_t WS_WFIN = 4 * MiB;
constexpr size_t WS_WFOUT = 15 * MiB;
constexpr size_t WS_WIN = 21 * MiB;
constexpr size_t WS_WBA = 32 * MiB;
constexpr size_t WS_WBB = 33 * MiB;
constexpr size_t WS_WOUT = 34 * MiB;
constexpr size_t WS_A = 36 * MiB;
constexpr size_t WS_O0 = 52 * MiB;
constexpr size_t WS_ACT = 68 * MiB;
constexpr size_t WS_GQ = 68 * MiB;
constexpr size_t WS_GK = 76 * MiB;
constexpr size_t WS_GLOG = 84 * MiB;
constexpr size_t WS_GV = 92 * MiB;
constexpr size_t WS_GR = 108 * MiB;
constexpr size_t WS_DQ = 124 * MiB;
constexpr size_t WS_DK = 140 * MiB;
constexpr size_t WS_DV = 156 * MiB;
constexpr size_t WS_GATES = 172 * MiB;
constexpr size_t WS_O1 = 236 * MiB;
constexpr size_t WS_Z = 124 * MiB;
constexpr size_t WS_END = 252 * MiB;

__device__ __forceinline__ float bf2f(bf16_t v) { return __uint_as_float(((unsigned)v) << 16); }
__device__ __forceinline__ bf16_t f2bf(float f) { unsigned u = __float_as_uint(f); return (bf16_t)((u + 0x7fffu + ((u >> 16) & 1u)) >> 16); }
__device__ __forceinline__ float sigmoidf_(float x) { return 1.f / (1.f + __expf(-x)); }
__device__ __forceinline__ float siluf_(float x) { return x / (1.f + __expf(-x)); }
__device__ __forceinline__ float logsigmoidf_(float x) { return fminf(x, 0.f) - log1pf(__expf(-fabsf(x))); }
__device__ __forceinline__ float wave_sum(float v) {
#pragma unroll
    for (int o = 1; o < 64; o <<= 1) v += __shfl_xor(v, o);
    return v;
}

__global__ void k_mod(const float* __restrict__ c, const float* __restrict__ w_ada, const float* __restrict__ b_ada, float* __restrict__ mod,
                      const float* lq1, const float* lk1, const float* lq2, const float* lk2, float* lam) {
    const int j = blockIdx.x * blockDim.x + threadIdx.x;
    if (j < NMOD) {
        float a0 = 0, a1 = 0, a2 = 0, a3 = 0;
        for (int k = 0; k < DM; ++k) {
            const float w = w_ada[(size_t)k * NMOD + j];
            a0 += siluf_(c[0 * DM + k]) * w; a1 += siluf_(c[1 * DM + k]) * w; a2 += siluf_(c[2 * DM + k]) * w; a3 += siluf_(c[3 * DM + k]) * w;
        }
        const float bb = b_ada[j];
        mod[0 * NMOD + j] = a0 + bb; mod[1 * NMOD + j] = a1 + bb; mod[2 * NMOD + j] = a2 + bb; mod[3 * NMOD + j] = a3 + bb;
    }
    if (blockIdx.x == 0 && threadIdx.x == 0) {
        float s1 = 0, s2 = 0;
        for (int i = 0; i < 64; ++i) { s1 += lq1[i] * lk1[i]; s2 += lq2[i] * lk2[i]; }
        lam[0] = expf(s1) - expf(s2) + LAM_INIT;
    }
}

__device__ __forceinline__ int win_srccol(int n) {
    if (n < 256) return n;
    if (n < 512) return n;
    if (n < 768) return -1;
    if (n < 1280) return 512 + (n - 768);
    if (n < 1792) return 1024 + (n - 1280);
    if (n < 2304) return 1552 + (n - 1792);
    if (n < 2816) return 2064 + (n - 2304);
    if (n < 3328) return 2576 + (n - 2816);
    return 3088 + (n - 3328);
}
__global__ void k_convert(const float* __restrict__ src, bf16_t* __restrict__ dst, int K, int N, int Nsrc, int mode, const float* __restrict__ w2) {
    const size_t idx = (size_t)blockIdx.x * blockDim.x + threadIdx.x;
    if (idx >= (size_t)N * K) return;
    const int n = (int)(idx / K), k = (int)(idx % K);
    float v;
    if (mode == 0) v = src[(size_t)k * Nsrc + n];
    else if (mode == 1) { const int pn = n >> 8, r = n & 255, half = r >> 7, i = r & 127; v = src[(size_t)k * Nsrc + half * FF + pn * 128 + i]; }
    else { const int sc = win_srccol(n);
        if (sc >= 0) v = src[(size_t)k * Nsrc + sc];
        else { const int j = n - 512; float a = 0; for (int r = 0; r < 16; ++r) a += src[(size_t)k * Nsrc + 1536 + r] * w2[r * 256 + j]; v = a; } }
    dst[idx] = f2bf(v);
}

__global__ void k_prep(const float* __restrict__ h, const float* __restrict__ g, const float* __restrict__ mod, int ish, int isc, bf16_t* __restrict__ A) {
    const int row = blockIdx.x * (blockDim.x >> 6) + (threadIdx.x >> 6), lane = threadIdx.x & 63;
    if (row >= M) return;
    const int b = row / SEQ;
    const float* hr = h + (size_t)row * DM; float v[16]; float s = 0;
#pragma unroll
    for (int j = 0; j < 16; ++j) { v[j] = hr[lane + 64 * j]; s += v[j] * v[j]; }
    const float rstd = rsqrtf(wave_sum(s) * (1.f / DM) + EPS);
    const float* sh = mod + (size_t)b * NMOD + ish * DM; const float* sc = mod + (size_t)b * NMOD + isc * DM;
#pragma unroll
    for (int j = 0; j < 16; ++j) { const int k = lane + 64 * j; A[(size_t)row * DM + k] = f2bf(v[j] * rstd * g[k] * (1.f + sc[k]) + sh[k]); }
}
__global__ void k_final(float* __restrict__ h, const float* __restrict__ g) {
    const int row = blockIdx.x * (blockDim.x >> 6) + (threadIdx.x >> 6), lane = threadIdx.x & 63;
    if (row >= M) return;
    float* hr = h + (size_t)row * DM; float v[16]; float s = 0;
#pragma unroll
    for (int j = 0; j < 16; ++j) { v[j] = hr[lane + 64 * j]; s += v[j] * v[j]; }
    const float rstd = rsqrtf(wave_sum(s) * (1.f / DM) + EPS);
#pragma unroll
    for (int j = 0; j < 16; ++j) { const int k = lane + 64 * j; hr[k] = v[j] * rstd * g[k]; }
}

template <bool PAIR, class Epi>
__global__ __launch_bounds__(256) void k_ngemm(const bf16_t* __restrict__ A, const bf16_t* __restrict__ Bt, int K, Epi epi) {
    __shared__ float As[32][65], Bs[32][65], Cs[PAIR ? 32 : 1][65];
    const int tx = threadIdx.x & 15, ty = threadIdx.x >> 4;
    const int row0 = blockIdx.y * 64;
    int col0 = blockIdx.x * 64;
    if (PAIR) col0 = (blockIdx.x >> 1) * 256 + (blockIdx.x & 1) * 64;
    float acc[4][4], acu[4][4];
#pragma unroll
    for (int i = 0; i < 4; ++i)
#pragma unroll
        for (int j = 0; j < 4; ++j) { acc[i][j] = 0.f; acu[i][j] = 0.f; }
    const int lr = threadIdx.x >> 2, lk = (threadIdx.x & 3) * 8;
    for (int k0 = 0; k0 < K; k0 += 32) {
        const uint4 va = *(const uint4*)(A + (size_t)(row0 + lr) * K + k0 + lk);
        const uint4 vb = *(const uint4*)(Bt + (size_t)(col0 + lr) * K + k0 + lk);
        const unsigned wa[4] = {va.x, va.y, va.z, va.w}, wb[4] = {vb.x, vb.y, vb.z, vb.w};
#pragma unroll
        for (int i = 0; i < 4; ++i) { As[lk + 2 * i][lr] = __uint_as_float(wa[i] << 16); As[lk + 2 * i + 1][lr] = __uint_as_float(wa[i] & 0xffff0000u);
                                      Bs[lk + 2 * i][lr] = __uint_as_float(wb[i] << 16); Bs[lk + 2 * i + 1][lr] = __uint_as_float(wb[i] & 0xffff0000u); }
        if (PAIR) { const uint4 vc = *(const uint4*)(Bt + (size_t)(col0 + 128 + lr) * K + k0 + lk); const unsigned wc[4] = {vc.x, vc.y, vc.z, vc.w};
#pragma unroll
            for (int i = 0; i < 4; ++i) { Cs[lk + 2 * i][lr] = __uint_as_float(wc[i] << 16); Cs[lk + 2 * i + 1][lr] = __uint_as_float(wc[i] & 0xffff0000u); } }
        __syncthreads();
#pragma unroll 8
        for (int k = 0; k < 32; ++k) {
            float a[4], b[4], c[4];
#pragma unroll
            for (int i = 0; i < 4; ++i) { a[i] = As[k][ty * 4 + i]; b[i] = Bs[k][tx * 4 + i]; c[i] = PAIR ? Cs[k][tx * 4 + i] : 0.f; }
#pragma unroll
            for (int i = 0; i < 4; ++i)
#pragma unroll
                for (int j = 0; j < 4; ++j) { acc[i][j] += a[i] * b[j]; if (PAIR) acu[i][j] += a[i] * c[j]; }
        }
        __syncthreads();
    }
#pragma unroll
    for (int i = 0; i < 4; ++i)
#pragma unroll
        for (int j = 0; j < 4; ++j) epi(row0 + ty * 4 + i, col0 + tx * 4 + j, acc[i][j], acu[i][j]);
}
struct NEpiSwiglu { bf16_t* act;
    __device__ void operator()(int row, int col, float g, float u) const { const int pn = col >> 8, i = col & 255; act[(size_t)row * FF + pn * 128 + i] = f2bf(siluf_(g) * u); } };
struct NEpiResid { const float* base; float* out; const float* mod; int igt; float scale;
    __device__ void operator()(int row, int col, float a, float) const { const int b = row / SEQ; out[(size_t)row * DM + col] = base[(size_t)row * DM + col] + scale * mod[(size_t)b * NMOD + igt * DM + col] * a; } };
struct NEpiProj { bf16_t* ws; const float* b2;
    __device__ void operator()(int row, int col, float a, float) const {
        unsigned char* w = (unsigned char*)ws;
        if (col < 256) ((bf16_t*)(w + WS_GQ))[(size_t)row * 256 + col] = f2bf(a * 0.125f);
        else if (col < 512) ((bf16_t*)(w + WS_GK))[(size_t)row * 256 + col - 256] = f2bf(a);
        else if (col < 768) ((bf16_t*)(w + WS_GLOG))[(size_t)row * 256 + col - 512] = f2bf(logsigmoidf_(a + b2[col - 512]) * (1.f / 16.f));
        else if (col < 1280) ((bf16_t*)(w + WS_GV))[(size_t)row * 512 + col - 768] = f2bf(a);
        else if (col < 1792) ((bf16_t*)(w + WS_GR))[(size_t)row * 512 + col - 1280] = f2bf(siluf_(a));
        else if (col < 2304) ((bf16_t*)(w + WS_DQ))[(size_t)row * 512 + col - 1792] = f2bf(a);
        else if (col < 2816) ((bf16_t*)(w + WS_DK))[(size_t)row * 512 + col - 2304] = f2bf(a);
        else if (col < 3328) ((bf16_t*)(w + WS_DV))[(size_t)row * 512 + col - 2816] = f2bf(a);
        else ((bf16_t*)(w + WS_GATES))[(size_t)row * 2048 + col - 3328] = f2bf(sigmoidf_(a));
    } };
struct NEpiBranch { const bf16_t* gates; bf16_t* tz; int second;
    __device__ void operator()(int row, int col, float a, float) const {
        const float g = bf2f(gates[(size_t)row * 2048 + second * 1024 + col]);
        float v = g * a; if (second) v += bf2f(tz[(size_t)row * DM + col]);
        tz[(size_t)row * DM + col] = f2bf(v); } };

__global__ __launch_bounds__(128) void k_gla_naive(const bf16_t* __restrict__ gq, const bf16_t* __restrict__ gk, const bf16_t* __restrict__ glog, bf16_t* gv_ya,
                                                   const bf16_t* __restrict__ gr, const float* __restrict__ gnorm) {
    const int b = blockIdx.x >> 2, h = blockIdx.x & 3, v = threadIdx.x;
    __shared__ float red[2]; __shared__ float sq[64], sk[64], sa[64];
    float S[64];
#pragma unroll
    for (int k = 0; k < 64; ++k) S[k] = 0.f;
    const float gn = gnorm[v];
    for (int t = 0; t < SEQ; ++t) {
        const size_t row = (size_t)b * SEQ + t;
        if (v < 64) { sq[v] = bf2f(gq[row * 256 + h * 64 + v]); sk[v] = bf2f(gk[row * 256 + h * 64 + v]); sa[v] = __expf(bf2f(glog[row * 256 + h * 64 + v])); }
        __syncthreads();
        const float vv = bf2f(gv_ya[row * 512 + h * 128 + v]);
        float o = 0.f;
#pragma unroll
        for (int k = 0; k < 64; ++k) { S[k] = sa[k] * S[k] + sk[k] * vv; o += sq[k] * S[k]; }
        const float ss = wave_sum(o * o);
        if ((v & 63) == 0) red[v >> 6] = ss;
        __syncthreads();
        const float rstd = rsqrtf((red[0] + red[1]) * (1.f / 128.f) + EPS);
        gv_ya[row * 512 + h * 128 + v] = f2bf(o * rstd * gn * bf2f(gr[row * 512 + h * 128 + v]));
    }
}

__global__ __launch_bounds__(64) void k_attn_naive(const bf16_t* __restrict__ dq, const bf16_t* __restrict__ dk, const bf16_t* __restrict__ dv, bf16_t* __restrict__ o0, bf16_t* __restrict__ o1) {
    const int qpos = blockIdx.x * 64 + threadIdx.x, bh = blockIdx.y >> 1, map = blockIdx.y & 1, b = bh >> 2, h = bh & 3, half = blockIdx.z;
    const float slope = exp2f(-2.f * (h + 1));
    float q[64];
    const size_t qrow = (size_t)b * SEQ + qpos;
#pragma unroll
    for (int d = 0; d < 64; ++d) q[d] = bf2f(dq[qrow * 512 + h * 128 + map * 64 + d]) * 0.125f;
    float m = -1e30f, l = 0.f, o[64];
#pragma unroll
    for (int d = 0; d < 64; ++d) o[d] = 0.f;
    const int jmax = blockIdx.x * 64 + 63;
    for (int j = 0; j <= jmax; ++j) {
        const size_t krow = (size_t)b * SEQ + j;
        const bf16_t* kp = dk + krow * 512 + h * 128 + map * 64;
        float s = 0.f;
#pragma unroll
        for (int d = 0; d < 64; ++d) s += q[d] * bf2f(kp[d]);
        s -= slope * (float)(qpos - j);
        if (j <= qpos) {
            const float mn = fmaxf(m, s), al = __expf(m - mn), p = __expf(s - mn);
            l = l * al + p; m = mn;
            const bf16_t* vp = dv + krow * 512 + h * 128 + half * 64;
#pragma unroll
            for (int d = 0; d < 64; ++d) o[d] = o[d] * al + p * bf2f(vp[d]);
        }
    }
    bf16_t* op = (map ? o1 : o0) + qrow * 512 + h * 128 + half * 64;
    const float il = 1.f / l;
#pragma unroll
    for (int d = 0; d < 64; ++d) op[d] = f2bf(o[d] * il);
}
__global__ void k_yb(bf16_t* o0_yb, const bf16_t* __restrict__ o1, const float* __restrict__ gnorm, const float* __restrict__ lam) {
    const int row = blockIdx.x * (blockDim.x >> 6) + (threadIdx.x >> 6), lane = threadIdx.x & 63;
    if (row >= M) return;
    const float lm = lam[0]; float d[8]; float s = 0;
#pragma unroll
    for (int i = 0; i < 8; ++i) { const size_t ix = (size_t)row * 512 + lane * 8 + i; d[i] = bf2f(o0_yb[ix]) - lm * bf2f(o1[ix]); s += d[i] * d[i]; }
    s += __shfl_xor(s, 1); s += __shfl_xor(s, 2); s += __shfl_xor(s, 4); s += __shfl_xor(s, 8);
    const float rstd = rsqrtf(s * (1.f / 128.f) + EPS);
#pragma unroll
    for (int i = 0; i < 8; ++i) { const int cidx = (lane * 8 + i) & 127; o0_yb[(size_t)row * 512 + lane * 8 + i] = f2bf(d[i] * rstd * gnorm[cidx] * (1.f - LAM_INIT)); }
}

extern "C" void kernel_launch(void* const* d_in, const int* in_sizes, int n_in, void* d_out, int out_size, void* d_ws, size_t ws_size, hipStream_t stream) {
    if (n_in != 24 || in_sizes[0] != M * DM || out_size != M * DM || ws_size < WS_END) { fprintf(stderr, "kernel_launch: unexpected shapes (n_in %d, ws %zu)\n", n_in, ws_size); return; }
    const float* x = (const float*)d_in[0]; const float* c = (const float*)d_in[1]; const float* w_ada = (const float*)d_in[2]; const float* b_ada = (const float*)d_in[3];
    const float* ffn1_norm = (const float*)d_in[4]; const float* ffn1_w_in = (const float*)d_in[5]; const float* ffn1_w_out = (const float*)d_in[6];
    const float* mix_norm = (const float*)d_in[7]; const float* w_in = (const float*)d_in[8]; const float* w2 = (const float*)d_in[9]; const float* b2 = (const float*)d_in[10];
    const float* gla_hn = (const float*)d_in[11]; const float* lq1 = (const float*)d_in[12]; const float* lk1 = (const float*)d_in[13]; const float* lq2 = (const float*)d_in[14]; const float* lk2 = (const float*)d_in[15];
    const float* diff_hn = (const float*)d_in[16]; const float* wba = (const float*)d_in[17]; const float* wbb = (const float*)d_in[18]; const float* wout = (const float*)d_in[19];
    const float* ffn2_norm = (const float*)d_in[20]; const float* ffn2_w_in = (const float*)d_in[21]; const float* ffn2_w_out = (const float*)d_in[22]; const float* final_norm = (const float*)d_in[23];
    unsigned char* ws = (unsigned char*)d_ws; float* out = (float*)d_out;
    float* mod = (float*)(ws + WS_MOD); float* lam = (float*)(ws + WS_LAM);
    bf16_t* wfin = (bf16_t*)(ws + WS_WFIN); bf16_t* wfout = (bf16_t*)(ws + WS_WFOUT); bf16_t* winT = (bf16_t*)(ws + WS_WIN);
    bf16_t* wbaT = (bf16_t*)(ws + WS_WBA); bf16_t* wbbT = (bf16_t*)(ws + WS_WBB); bf16_t* woutT = (bf16_t*)(ws + WS_WOUT);
    bf16_t* A = (bf16_t*)(ws + WS_A); bf16_t* act = (bf16_t*)(ws + WS_ACT);
    bf16_t* gq = (bf16_t*)(ws + WS_GQ); bf16_t* gk = (bf16_t*)(ws + WS_GK); bf16_t* glog = (bf16_t*)(ws + WS_GLOG); bf16_t* gv = (bf16_t*)(ws + WS_GV); bf16_t* gr = (bf16_t*)(ws + WS_GR);
    bf16_t* dq = (bf16_t*)(ws + WS_DQ); bf16_t* dk = (bf16_t*)(ws + WS_DK); bf16_t* dv = (bf16_t*)(ws + WS_DV); bf16_t* gates = (bf16_t*)(ws + WS_GATES);
    bf16_t* o0 = (bf16_t*)(ws + WS_O0); bf16_t* o1 = (bf16_t*)(ws + WS_O1); bf16_t* tz = (bf16_t*)(ws + WS_Z);
    auto conv = [&](const float* src, bf16_t* dst, int K, int N, int Nsrc, int mode) { const size_t tot = (size_t)N * K; k_convert<<<dim3((unsigned)((tot + 255) / 256)), 256, 0, stream>>>(src, dst, K, N, Nsrc, mode, w2); };

    k_mod<<<NMOD / 256, 256, 0, stream>>>(c, w_ada, b_ada, mod, lq1, lk1, lq2, lk2, lam);
    conv(ffn1_w_in, wfin, DM, 2 * FF, 2 * FF, 1); conv(ffn1_w_out, wfout, FF, DM, DM, 0); conv(w_in, winT, DM, NPROJ, WIN_COLS, 2);
    conv(wba, wbaT, 512, DM, DM, 0); conv(wbb, wbbT, 512, DM, DM, 0); conv(wout, woutT, DM, DM, DM, 0);
    k_prep<<<M / 4, 256, 0, stream>>>(x, ffn1_norm, mod, 0, 1, A);
    k_ngemm<true, NEpiSwiglu><<<dim3(2 * FF / 256 * 2, M / 64), 256, 0, stream>>>(A, wfin, DM, NEpiSwiglu{act});
    k_ngemm<false, NEpiResid><<<dim3(DM / 64, M / 64), 256, 0, stream>>>(act, wfout, FF, NEpiResid{x, out, mod, 2, 0.5f});
    k_prep<<<M / 4, 256, 0, stream>>>(out, mix_norm, mod, 3, 4, A);
    k_ngemm<false, NEpiProj><<<dim3(NPROJ / 64, M / 64), 256, 0, stream>>>(A, winT, DM, NEpiProj{(bf16_t*)ws, b2});
    k_gla_naive<<<16, 128, 0, stream>>>(gq, gk, glog, gv, gr, gla_hn);
    k_attn_naive<<<dim3(SEQ / 64, 32, 2), 64, 0, stream>>>(dq, dk, dv, o0, o1);
    k_yb<<<M / 4, 256, 0, stream>>>(o0, o1, diff_hn, lam);
    k_ngemm<false, NEpiBranch><<<dim3(DM / 64, M / 64), 256, 0, stream>>>(gv, wbaT, 512, NEpiBranch{gates, tz, 0});
    k_ngemm<false, NEpiBranch><<<dim3(DM / 64, M / 64), 256, 0, stream>>>(o0, wbbT, 512, NEpiBranch{gates, tz, 1});
    k_ngemm<false, NEpiResid><<<dim3(DM / 64, M / 64), 256, 0, stream>>>(tz, woutT, DM, NEpiResid{out, out, mod, 5, 1.0f});
    conv(ffn2_w_in, wfin, DM, 2 * FF, 2 * FF, 1); conv(ffn2_w_out, wfout, FF, DM, DM, 0);
    k_prep<<<M / 4, 256, 0, stream>>>(out, ffn2_norm, mod, 6, 7, A);
    k_ngemm<true, NEpiSwiglu><<<dim3(2 * FF / 256 * 2, M / 64), 256, 0, stream>>>(A, wfin, DM, NEpiSwiglu{act});
    k_ngemm<false, NEpiResid><<<dim3(DM / 64, M / 64), 256, 0, stream>>>(act, wfout, FF, NEpiResid{out, out, mod, 8, 0.5f});
    k_final<<<M / 4, 256, 0, stream>>>(out, final_norm);
}
```
